# Optimizing an MI355X kernel written in HIP

```python
import math
import jax
import jax.numpy as jnp
from jax import lax
import numpy as np

D_MODEL = 1024
BATCH = 2
SEQ = 8192
DEPTH = 1

ATTN_WIDTH = D_MODEL // 2
HYENA_WIDTH = D_MODEL - ATTN_WIDTH
DA_HEADS = 4
DA_HEAD_DIM = ATTN_WIDTH // (2 * DA_HEADS)
DA_V_DIM = 2 * DA_HEAD_DIM
ROT_DIM = DA_HEAD_DIM // 4
ROPE_THETA = 500000.0
Q_BLOCK = 128
IN_COLS = 3 * ATTN_WIDTH + 3 * HYENA_WIDTH

SHORT_CONV = 3
FILTER_EMB = 33
FILTER_BANDS = (FILTER_EMB - 1) // 2
FILTER_ORDER = 64
DECAY_TARGET = 1e-2
FAST_DECAY = 0.3
SLOW_DECAY = 1.5

N_EXPERTS = 256
TOP_K = 8
N_GROUPS = 8
TOPK_GROUPS = 4
EXPERT_DIM = 256
ROUTED_SCALE = 2.5
MOE_BLOCK = 64

ALPHA = (2 * DEPTH) ** 0.25
BETA = (8 * DEPTH) ** -0.25
LN_EPS = 1e-5

kernel_name = 'hybrid_diffattn_hyena_moe_encoder'


def _f32(a):
    return a.astype(jnp.float32)


def layer_norm(x, g, b):
    xf = _f32(x)
    mu = jnp.mean(xf, axis=-1, keepdims=True)
    var = jnp.mean(jnp.square(xf - mu), axis=-1, keepdims=True)
    y = (xf - mu) * lax.rsqrt(var + LN_EPS) * _f32(g) + _f32(b)
    return y.astype(x.dtype)


def rms_norm(x, g):
    xf = _f32(x)
    y = xf * lax.rsqrt(jnp.mean(jnp.square(xf), axis=-1, keepdims=True) + LN_EPS) * _f32(g)
    return y.astype(x.dtype)


def rotary_tables(positions):
    inv_freq = ROPE_THETA ** (-jnp.arange(0, ROT_DIM, 2, dtype=jnp.float32) / ROT_DIM)
    ang = _f32(positions)[..., None] * inv_freq
    return jnp.cos(ang), jnp.sin(ang)


def apply_partial_rotary(t, cos, sin):
    half = ROT_DIM // 2
    t1 = t[..., :half]
    t2 = t[..., half:ROT_DIM]
    return jnp.concatenate([t1 * cos - t2 * sin, t2 * cos + t1 * sin, t[..., ROT_DIM:]], axis=-1)


def differential_attention(q, k, v, lam, lam_init, subln_g):
    B, L, H = q.shape[0], q.shape[1], q.shape[2]
    nb = L // Q_BLOCK
    scale = DA_HEAD_DIM ** -0.5
    qb = (q * scale).reshape(B, nb, Q_BLOCK, H, 2, DA_HEAD_DIM).transpose(1, 0, 3, 4, 2, 5)
    kt = k.transpose(0, 2, 3, 1, 4)
    vt = v.transpose(0, 2, 1, 3)
    lam_c = lam.astype(v.dtype)

    def block(q_blk):
        s = _f32(jnp.einsum('bhcqd,bhckd->bhcqk', q_blk, kt))
        p = jax.nn.softmax(s, axis=-1).astype(vt.dtype)
        o = jnp.einsum('bhcqk,bhkv->bhcqv', p, vt)
        return o[:, :, 0] - lam_c * o[:, :, 1]

    o = lax.map(block, qb)
    o = o.transpose(1, 0, 3, 2, 4).reshape(B, L, H, DA_V_DIM)
    o = rms_norm(o, subln_g) * (1.0 - lam_init)
    return o.reshape(B, L, H * DA_V_DIM)


def short_conv(u, w, b):
    C = u.shape[-1]
    pad = SHORT_CONV // 2
    y = lax.conv_general_dilated(u, w[:, None, :].astype(u.dtype), window_strides=(1,),
                                 padding=[(pad, pad)], dimension_numbers=('NWC', 'WIO', 'NWC'),
                                 feature_group_count=C)
    return y + b.astype(u.dtype)


def hyena_long_filter(L, w1, b1, w2, b2, w3, b3, freq, wout):
    C = wout.shape[-1] // 2
    t = jnp.linspace(0.0, 1.0, L, dtype=jnp.float32)[:, None]
    w = 2.0 * math.pi * jnp.arange(L, dtype=jnp.float32)[:, None] / L
    f = jnp.linspace(1e-4, FILTER_BANDS - 1, FILTER_BANDS, dtype=jnp.float32)[None, :]
    z = jnp.concatenate([t, jnp.cos(f * w), -jnp.sin(f * w)], axis=-1)
    freq = _f32(freq)
    h = jnp.sin(freq[0] * (z @ _f32(w1) + _f32(b1)))
    h = jnp.sin(freq[1] * (h @ _f32(w2) + _f32(b2)))
    h = jnp.sin(freq[2] * (h @ _f32(w3) + _f32(b3)))
    h = h @ _f32(wout)
    deltas = jnp.abs(jnp.linspace(math.log(DECAY_TARGET) / SLOW_DECAY,
                                  math.log(DECAY_TARGET) / FAST_DECAY, C, dtype=jnp.float32))
    decay = jnp.exp(-t * deltas)
    h_fwd = h[:, :C] * decay
    h_bwd = h[:, C:] * decay
    taps = jnp.concatenate([h_fwd, jnp.zeros((1, C), jnp.float32), jnp.flip(h_bwd[1:], axis=0)], axis=0)
    taps = taps / jnp.sum(jnp.abs(taps), axis=0, keepdims=True)
    return jnp.fft.rfft(taps, axis=0)


def hyena_mixer(u, conv_w, conv_b, w1, b1, w2, b2, w3, b3, freq, wout, d_skip):
    L = u.shape[1]
    u = short_conv(u, conv_w, conv_b)
    x0, x1, v = jnp.split(u, 3, axis=-1)
    v = v * x1
    filt = hyena_long_filter(L, w1, b1, w2, b2, w3, b3, freq, wout)
    vf = jnp.fft.rfft(_f32(v), n=2 * L, axis=1)
    y = jnp.fft.irfft(vf * filt[None], n=2 * L, axis=1)[:, :L]
    y = y.astype(v.dtype) + v * d_skip.astype(v.dtype)
    return x0 * y


def route(xt, w_router, bias):
    T = xt.shape[0]
    scores = jax.nn.sigmoid(_f32(xt @ w_router))
    biased = scores + _f32(bias)
    grp = biased.reshape(T, N_GROUPS, N_EXPERTS // N_GROUPS)
    grp_score = jnp.sum(lax.top_k(grp, 2)[0], axis=-1)
    _, top_groups = lax.top_k(grp_score, TOPK_GROUPS)
    group_mask = jnp.any(top_groups[..., None] == jnp.arange(N_GROUPS)[None, None, :], axis=1)
    expert_mask = jnp.repeat(group_mask, N_EXPERTS // N_GROUPS, axis=1)
    _, idx = lax.top_k(jnp.where(expert_mask, biased, -jnp.inf), TOP_K)
    gates = jnp.take_along_axis(scores, idx, axis=1)
    gates = gates / jnp.sum(gates, axis=-1, keepdims=True) * ROUTED_SCALE
    return gates, idx


def routed_experts(xt, gates, idx, w_gate, w_up, w_down):
    T, D = xt.shape
    A = T * TOP_K
    nb = -(-A // MOE_BLOCK) + N_EXPERTS
    P = nb * MOE_BLOCK
    flat_e = idx.reshape(A)
    order = jnp.argsort(flat_e)
    sorted_e = flat_e[order]
    counts = jnp.bincount(flat_e, length=N_EXPERTS)
    padded = (counts + MOE_BLOCK - 1) // MOE_BLOCK * MOE_BLOCK
    pad_end = jnp.cumsum(padded)
    pad_start = pad_end - padded
    grp_start = jnp.cumsum(counts) - counts
    dest = pad_start[sorted_e] + jnp.arange(A, dtype=jnp.int32) - grp_start[sorted_e]
    row_tok = jnp.full((P,), T, jnp.int32).at[dest].set((order // TOP_K).astype(jnp.int32))
    row_gate = jnp.zeros((P,), xt.dtype).at[dest].set(gates.reshape(A)[order].astype(xt.dtype))
    block_expert = jnp.minimum(jnp.searchsorted(pad_end, jnp.arange(nb, dtype=jnp.int32) * MOE_BLOCK, side='right'),
                               N_EXPERTS - 1)
    x_pad = jnp.concatenate([xt, jnp.zeros((1, D), xt.dtype)], axis=0)

    def block(args):
        rows, e = args
        xb = x_pad[rows]
        hb = jax.nn.silu(xb @ w_gate[e]) * (xb @ w_up[e])
        return hb @ w_down[e]

    out = lax.map(block, (row_tok.reshape(nb, MOE_BLOCK), block_expert)).reshape(P, D)
    return jax.ops.segment_sum(out * row_gate[:, None], row_tok, num_segments=T + 1)[:T]


def swiglu(x, w_g, w_u, w_d):
    return (jax.nn.silu(x @ w_g) * (x @ w_u)) @ w_d


def setup_inputs(seed: int = 0) -> dict:
    key = jax.random.key(seed)
    ks = jax.random.split(key, 40)
    C = HYENA_WIDTH

    def nrm(k, shape, scale):
        return jax.random.normal(k, shape, jnp.float32) * scale

    x = nrm(ks[0], (BATCH, SEQ, D_MODEL), 1.0)
    offsets = jax.random.randint(ks[1], (BATCH, 1), 0, SEQ, dtype=jnp.int32)
    positions = offsets + jnp.arange(SEQ, dtype=jnp.int32)[None, :]
    return {
        'x': x,
        'positions': positions,
        'emb_ln_g': 1.0 + nrm(ks[2], (D_MODEL,), 0.02),
        'emb_ln_b': nrm(ks[3], (D_MODEL,), 0.02),
        'w_in': nrm(ks[4], (DEPTH, D_MODEL, IN_COLS), D_MODEL ** -0.5),
        'hy_conv_w': nrm(ks[5], (DEPTH, SHORT_CONV, 3 * C), SHORT_CONV ** -0.5),
        'hy_conv_b': nrm(ks[6], (DEPTH, 3 * C), 0.02),
        'hy_f_w1': nrm(ks[7], (DEPTH, FILTER_EMB, FILTER_ORDER), FILTER_EMB ** -0.5),
        'hy_f_b1': nrm(ks[8], (DEPTH, FILTER_ORDER), 0.1),
        'hy_f_w2': nrm(ks[9], (DEPTH, FILTER_ORDER, FILTER_ORDER), FILTER_ORDER ** -0.5),
        'hy_f_b2': nrm(ks[10], (DEPTH, FILTER_ORDER), 0.1),
        'hy_f_w3': nrm(ks[11], (DEPTH, FILTER_ORDER, FILTER_ORDER), FILTER_ORDER ** -0.5),
        'hy_f_b3': nrm(ks[12], (DEPTH, FILTER_ORDER), 0.1),
        'hy_f_freq': 1.0 + nrm(ks[13], (DEPTH, 3, FILTER_ORDER), 0.01),
        'hy_f_wout': nrm(ks[14], (DEPTH, FILTER_ORDER, 2 * C), FILTER_ORDER ** -0.5),
        'hy_d': nrm(ks[15], (DEPTH, C), 0.1),
        'lambda_q1': nrm(ks[16], (DEPTH, DA_HEAD_DIM), 0.1),
        'lambda_k1': nrm(ks[17], (DEPTH, DA_HEAD_DIM), 0.1),
        'lambda_q2': nrm(ks[18], (DEPTH, DA_HEAD_DIM), 0.1),
        'lambda_k2': nrm(ks[19], (DEPTH, DA_HEAD_DIM), 0.1),
        'subln_g': 1.0 + nrm(ks[20], (DEPTH, DA_V_DIM), 0.02),
        'w_o': nrm(ks[21], (DEPTH, D_MODEL, D_MODEL), BETA * D_MODEL ** -0.5),
        'ln1_g': 1.0 + nrm(ks[22], (DEPTH, D_MODEL), 0.02),
        'ln1_b': nrm(ks[23], (DEPTH, D_MODEL), 0.02),
        'w_router': nrm(ks[24], (DEPTH, D_MODEL, N_EXPERTS), D_MODEL ** -0.5),
        'router_bias': nrm(ks[25], (DEPTH, N_EXPERTS), 0.01),
        'w_gate': nrm(ks[26], (DEPTH, N_EXPERTS, D_MODEL, EXPERT_DIM), D_MODEL ** -0.5),
        'w_up': nrm(ks[27], (DEPTH, N_EXPERTS, D_MODEL, EXPERT_DIM), D_MODEL ** -0.5),
        'w_down': nrm(ks[28], (DEPTH, N_EXPERTS, EXPERT_DIM, D_MODEL), BETA * EXPERT_DIM ** -0.5),
        'ws_gate': nrm(ks[29], (DEPTH, D_MODEL, EXPERT_DIM), D_MODEL ** -0.5),
        'ws_up': nrm(ks[30], (DEPTH, D_MODEL, EXPERT_DIM), D_MODEL ** -0.5),
        'ws_down': nrm(ks[31], (DEPTH, EXPERT_DIM, D_MODEL), BETA * EXPERT_DIM ** -0.5),
        'ln2_g': 1.0 + nrm(ks[32], (DEPTH, D_MODEL), 0.02),
        'ln2_b': nrm(ks[33], (DEPTH, D_MODEL), 0.02),
    }


def reference(x, positions, emb_ln_g, emb_ln_b, w_in, hy_conv_w, hy_conv_b, hy_f_w1, hy_f_b1,
              hy_f_w2, hy_f_b2, hy_f_w3, hy_f_b3, hy_f_freq, hy_f_wout, hy_d, lambda_q1, lambda_k1,
              lambda_q2, lambda_k2, subln_g, w_o, ln1_g, ln1_b, w_router, router_bias, w_gate, w_up,
              w_down, ws_gate, ws_up, ws_down, ln2_g, ln2_b):
    B, L, D = x.shape
    cos, sin = rotary_tables(positions)
    cos = cos[:, :, None, None, :].astype(x.dtype)
    sin = sin[:, :, None, None, :].astype(x.dtype)
    h = layer_norm(x, emb_ln_g, emb_ln_b)
    for i in range(DEPTH):
        proj = h @ w_in[i]
        q = proj[..., :ATTN_WIDTH].reshape(B, L, DA_HEADS, 2, DA_HEAD_DIM)
        k = proj[..., ATTN_WIDTH:2 * ATTN_WIDTH].reshape(B, L, DA_HEADS, 2, DA_HEAD_DIM)
        v = proj[..., 2 * ATTN_WIDTH:3 * ATTN_WIDTH].reshape(B, L, DA_HEADS, DA_V_DIM)
        u = proj[..., 3 * ATTN_WIDTH:]
        q = apply_partial_rotary(q, cos, sin)
        k = apply_partial_rotary(k, cos, sin)
        lam_init = 0.8 - 0.6 * math.exp(-0.3 * i)
        lam = (jnp.exp(jnp.sum(_f32(lambda_q1[i]) * _f32(lambda_k1[i])))
               - jnp.exp(jnp.sum(_f32(lambda_q2[i]) * _f32(lambda_k2[i]))) + lam_init)
        attn_out = differential_attention(q, k, v, lam, lam_init, subln_g[i])
        hy_out = hyena_mixer(u, hy_conv_w[i], hy_conv_b[i], hy_f_w1[i], hy_f_b1[i], hy_f_w2[i],
                             hy_f_b2[i], hy_f_w3[i], hy_f_b3[i], hy_f_freq[i], hy_f_wout[i], hy_d[i])
        mixed = jnp.concatenate([attn_out, hy_out], axis=-1) @ w_o[i]
        h = layer_norm(ALPHA * h + mixed, ln1_g[i], ln1_b[i])
        ht = h.reshape(B * L, D)
        gates, idx = route(ht, w_router[i], router_bias[i])
        ffn = swiglu(ht, ws_gate[i], ws_up[i], ws_down[i]) + routed_experts(ht, gates, idx, w_gate[i], w_up[i], w_down[i])
        h = layer_norm(ALPHA * h + ffn.reshape(B, L, D), ln2_g[i], ln2_b[i])
    return h
```

```cpp
#include <hip/hip_runtime.h>
#include <cstdio>
#include <cstdint>

#ifndef MK_LAUNCHES
#define MK_LAUNCHES 1
#endif

#ifndef DEBUG_TAP
#define DEBUG_TAP -1
#endif
#ifndef PH_MASK
#define PH_MASK 0xFFF
#endif
#define LAS __attribute__((address_space(3)))
typedef unsigned short bf16_t;
typedef short bf16x8 __attribute__((ext_vector_type(8)));
typedef short s16x4 __attribute__((ext_vector_type(4)));
typedef float f32x4 __attribute__((ext_vector_type(4)));
typedef float f32x2 __attribute__((ext_vector_type(2)));
typedef float f32x16 __attribute__((ext_vector_type(16)));
typedef unsigned u32x4 __attribute__((ext_vector_type(4)));
typedef unsigned u32x2 __attribute__((ext_vector_type(2)));

constexpr int T = 16384, DM = 1024, SEQ = 8192, NBATCH = 2, INC = 3072, CH = 512, NE = 256, ED = 256, TOPK = 8;
constexpr int NSLOT = T * TOPK;
constexpr float LN_EPS = 1e-5f;
constexpr float ALPHA = 1.189207115002721f;
constexpr float QSCALE = 0.125f * 1.4426950408889634f;
constexpr int NPHASE = (DEBUG_TAP >= 0) ? 13 : 12;
constexpr int NFFT = 16384;

constexpr size_t MiB = 1u << 20;
constexpr size_t WS_CTL = 0;
constexpr size_t CTL_BYTES = 16384;
constexpr size_t CTL_CNT_OFF = 14336;
constexpr size_t WS_TW = 1 * MiB;
constexpr size_t WS_GATES = 2 * MiB;
constexpr size_t WS_SLOTE = 3 * MiB;
constexpr size_t WS_H0B = 16 * MiB;
constexpr size_t WS_PROJ = 48 * MiB;
constexpr size_t WS_X0 = 144 * MiB;
constexpr size_t WS_VXT = 160 * MiB;
constexpr size_t WS_YT = 192 * MiB;
constexpr size_t WS_HFILT = 224 * MiB;
constexpr size_t WS_CONCAT = 256 * MiB;
constexpr size_t WS_YSLOTS = 16 * MiB;
constexpr size_t WS_ASCR = 288 * MiB;
constexpr size_t WS_GS = 320 * MiB;
constexpr size_t WS_R1 = 352 * MiB;
constexpr size_t WS_H1F = 416 * MiB;
constexpr size_t WS_H1B = 480 * MiB;
constexpr size_t WS_LOGITS = 512 * MiB;
constexpr size_t WS_HS = 528 * MiB;
constexpr size_t WS_HEXP = 544 * MiB;
constexpr size_t WS_YSH = 608 * MiB;
constexpr size_t WS_LISTS = 672 * MiB;
constexpr size_t WS_END = 688 * MiB;

constexpr int LDS_MISC = 135168;
constexpr int LDS_BYTES = 139264;

typedef __bf16 bf2_t __attribute__((ext_vector_type(2)));
__device__ __forceinline__ unsigned cvt_pk_bf16(float lo, float hi) { bf2_t v; v[0] = (__bf16)lo; v[1] = (__bf16)hi; return __builtin_bit_cast(unsigned, v); }
__device__ __forceinline__ bf16_t f2bf(float f) { return __builtin_bit_cast(unsigned short, (__bf16)f); }
__device__ __forceinline__ float bf2f(unsigned short b) { return __builtin_bit_cast(float, (unsigned)b << 16); }
__device__ __forceinline__ float bflo(unsigned w) { return __builtin_bit_cast(float, w << 16); }
__device__ __forceinline__ float bfhi(unsigned w) { return __builtin_bit_cast(float, w & 0xffff0000u); }
__device__ __forceinline__ float wave_sum(float v) {
#pragma unroll
    for (int o = 32; o >= 1; o >>= 1) v += __shfl_xor(v, o);
    return v;
}

#define XB_TMO      128
#define XB_XCNT(j)  (256  + 64 * (j))
#define XB_XSUB(j)  (1280 + 64 * (j))
#define XB_XGEN(j)  (2304 + 64 * (j))
#define XB_TOP      3328
#define XB_TOPGEN   3392
#define XCD_BAR_WORDS 3456
#define XB_SPIN_CAP (1u << 18)

__device__ __forceinline__ unsigned xb_ld(unsigned* p)              { return __hip_atomic_load(p, __ATOMIC_RELAXED, __HIP_MEMORY_SCOPE_AGENT); }
__device__ __forceinline__ unsigned xb_add(unsigned* p, unsigned v) { return __hip_atomic_fetch_add(p, v, __ATOMIC_RELAXED, __HIP_MEMORY_SCOPE_AGENT); }
__device__ __forceinline__ unsigned xb_xcc_id() { return (unsigned)__builtin_amdgcn_s_getreg((3 << 11) | 20) & 0xFu; }
#define XB_SPIN(cond, bar) do { unsigned _sp = 0; while (cond) { __builtin_amdgcn_s_sleep(1); \
    if ((++_sp & 255u) == 0u) { if (xb_ld(&(bar)[XB_TMO])) break; if (_sp > XB_SPIN_CAP) { atomicAdd(&(bar)[XB_TMO], 1u); break; } } } } while (0)

struct XcdBarrier {
    unsigned* bar; unsigned x;
    volatile LAS unsigned* st;
};
__device__ __forceinline__ XcdBarrier xcd_barrier_post(unsigned* bar, volatile LAS unsigned* st) {
    XcdBarrier b; b.bar = bar; b.x = xb_xcc_id(); b.st = st;
    if (threadIdx.x == 0) (void)xb_add(&bar[XB_XCNT(b.x)], 1u);
    return b;
}
__device__ __forceinline__ void xcd_barrier_complete(unsigned* bar, unsigned x, unsigned& nloc, unsigned& nx) {
    const unsigned G = gridDim.x * gridDim.y * gridDim.z;
    unsigned sum, cnt, mine, sp = 0u;
    for (;;) {
        sum = 0u; cnt = 0u; mine = 0u;
#pragma unroll
        for (unsigned j = 0; j < 16; ++j) { const unsigned c = xb_ld(&bar[XB_XCNT(j)]); sum += c; cnt += (c > 0u) ? 1u : 0u; mine = (j == x) ? c : mine; }
        if (sum == G) break;
        __builtin_amdgcn_s_sleep(1);
        if ((++sp & 255u) == 0u) { if (xb_ld(&bar[XB_TMO])) break; if (sp > XB_SPIN_CAP) { atomicAdd(&bar[XB_TMO], 1u); break; } }
    }
    nloc = mine > 0u ? mine : 1u; nx = cnt > 0u ? cnt : 1u;
}
__device__ __forceinline__ void xcd_barrier(const XcdBarrier& b) {
    asm volatile("s_waitcnt vmcnt(0)" ::: "memory");
    __syncthreads();
    if (threadIdx.x == 0) {
        unsigned* bar = b.bar;
        __builtin_amdgcn_s_waitcnt(0);
        unsigned nloc = b.st[0], nx = b.st[1];
        if (nloc == 0u) { xcd_barrier_complete(bar, b.x, nloc, nx); b.st[0] = nloc; b.st[1] = nx; }
        const unsigned old = xb_add(&bar[XB_XSUB(b.x)], 1u);
        const unsigned gen = old / nloc;
        if (old + 1u == (gen + 1u) * nloc) {
            __builtin_amdgcn_fence(__ATOMIC_RELEASE, "agent");
            asm volatile("s_waitcnt vmcnt(0)" ::: "memory");
            const unsigned og = xb_add(&bar[XB_TOP], 1u);
            const unsigned tg = og / nx;
            if (og + 1u == (tg + 1u) * nx) xb_add(&bar[XB_TOPGEN], 1u);
            else XB_SPIN(xb_ld(&bar[XB_TOPGEN]) == tg, bar);
            __builtin_amdgcn_fence(__ATOMIC_ACQUIRE, "agent");
            xb_add(&bar[XB_XGEN(b.x)], 1u);
            asm volatile("s_waitcnt vmcnt(0)" ::: "memory");
        } else {
            XB_SPIN(xb_ld(&bar[XB_XGEN(b.x)]) == gen, bar);
            __builtin_amdgcn_fence(__ATOMIC_ACQUIRE, "agent");
            asm volatile("s_waitcnt vmcnt(0)" ::: "memory");
        }
    }
    __syncthreads();
}

constexpr int LDT = 144;

template <int NCH> struct LdBf16 {
    const unsigned char* base; unsigned off[NCH]; int ldsoff;
    typedef u32x4 Raw;
    __device__ __forceinline__ Raw issue(int i, int kt) const { return *(const u32x4*)(base + off[i] + (size_t)kt * 128); }
    __device__ __forceinline__ void store(int i, int kt, const Raw& r, LAS unsigned char* tile) const { *(LAS u32x4*)(tile + ldsoff + i * 64 * LDT) = r; }
};
template <int NCH, bool HILO> struct LdF32Rows {
    const unsigned char* base; unsigned off[NCH]; int ldsoff;
    struct Raw { f32x4 a, b; };
    __device__ __forceinline__ Raw issue(int i, int kt) const {
        const int kk = HILO ? (kt & 15) : kt;
        const f32x4* p = (const f32x4*)(base + off[i] + (size_t)kk * 256); Raw r; r.a = p[0]; r.b = p[1]; return r; }
    __device__ __forceinline__ void store(int i, int kt, const Raw& r, LAS unsigned char* tile) const {
        float v[8] = {r.a[0], r.a[1], r.a[2], r.a[3], r.b[0], r.b[1], r.b[2], r.b[3]};
        u32x4 w;
        if (HILO && (kt >> 4) == 1) {
#pragma unroll
            for (int j = 0; j < 8; ++j) { const unsigned h = f2bf(v[j]); v[j] = v[j] - bflo(h); }
        }
        w.x = cvt_pk_bf16(v[0], v[1]); w.y = cvt_pk_bf16(v[2], v[3]); w.z = cvt_pk_bf16(v[4], v[5]); w.w = cvt_pk_bf16(v[6], v[7]);
        *(LAS u32x4*)(tile + ldsoff + i * 64 * LDT) = w; }
};
template <int BN, bool HILO> struct LdF32KN {
    const float* p; int N; float scale; int kc0; int ldsoff;
    struct Raw { float v[8]; };
    __device__ __forceinline__ Raw issue(int i, int kt) const {
        const int kk = HILO ? (kt & 15) : kt;
        const float* q = p + (size_t)(kk * 64 + i * (512 / BN) * 8) * N; Raw r;
#pragma unroll
        for (int j = 0; j < 8; ++j) r.v[j] = q[(size_t)j * N];
        return r; }
    __device__ __forceinline__ void store(int i, int kt, const Raw& r, LAS unsigned char* tile) const {
        float v[8];
#pragma unroll
        for (int j = 0; j < 8; ++j) v[j] = r.v[j] * scale;
        if (HILO && (kt >> 4) == 2) {
#pragma unroll
            for (int j = 0; j < 8; ++j) { const unsigned h = f2bf(v[j]); v[j] = v[j] - bflo(h); }
        }
        u32x4 w; w.x = cvt_pk_bf16(v[0], v[1]); w.y = cvt_pk_bf16(v[2], v[3]); w.z = cvt_pk_bf16(v[4], v[5]); w.w = cvt_pk_bf16(v[6], v[7]);
        *(LAS u32x4*)(tile + ldsoff + i * (512 / BN) * 16) = w; }
};

template <int BM, int BN, class LA, class LB, class Epi>
__device__ __forceinline__ void gemm_tile(LAS unsigned char* lds, const LA& la, const LB& lb, int nk, const Epi& epi) {
    constexpr int WN = BN / 64, NA = BM * 8 / 512, NB = BN * 8 / 512;
    const int tid = threadIdx.x, lane = tid & 63, wid = __builtin_amdgcn_readfirstlane(tid >> 6);
    const int wr = wid / WN, wc = wid % WN, fr = lane & 15, fq = lane >> 4;
    LAS unsigned char* As = lds; LAS unsigned char* Bs = lds + BM * LDT;
    f32x4 acc[4][4];
#pragma unroll
    for (int m = 0; m < 4; ++m)
#pragma unroll
        for (int n = 0; n < 4; ++n) acc[m][n] = (f32x4){0.f, 0.f, 0.f, 0.f};
    typename LA::Raw ra[NA]; typename LB::Raw rb[NB];
#pragma unroll
    for (int i = 0; i < NA; ++i) ra[i] = la.issue(i, 0);
#pragma unroll
    for (int i = 0; i < NB; ++i) rb[i] = lb.issue(i, 0);
#pragma unroll
    for (int i = 0; i < NA; ++i) la.store(i, 0, ra[i], As);
#pragma unroll
    for (int i = 0; i < NB; ++i) lb.store(i, 0, rb[i], Bs);
    __syncthreads();
    const int aoff = (wr * 64 + fr) * LDT + fq * 16, boff = (wc * 64 + fr) * LDT + fq * 16;
    for (int kt = 0; kt < nk; ++kt) {
        const bool more = kt + 1 < nk;
        if (more) {
#pragma unroll
            for (int i = 0; i < NA; ++i) ra[i] = la.issue(i, kt + 1);
#pragma unroll
            for (int i = 0; i < NB; ++i) rb[i] = lb.issue(i, kt + 1);
        }
#pragma unroll
        for (int kk = 0; kk < 2; ++kk) {
            bf16x8 a[4], b[4];
#pragma unroll
            for (int m = 0; m < 4; ++m) a[m] = *(const LAS bf16x8*)(As + aoff + m * 16 * LDT + kk * 64);
#pragma unroll
            for (int n = 0; n < 4; ++n) b[n] = *(const LAS bf16x8*)(Bs + boff + n * 16 * LDT + kk * 64);
#pragma unroll
            for (int m = 0; m < 4; ++m)
#pragma unroll
                for (int n = 0; n < 4; ++n) acc[m][n] = __builtin_amdgcn_mfma_f32_16x16x32_bf16(a[m], b[n], acc[m][n], 0, 0, 0);
        }
        __syncthreads();
        if (more) {
#pragma unroll
            for (int i = 0; i < NA; ++i) la.store(i, kt + 1, ra[i], As);
#pragma unroll
            for (int i = 0; i < NB; ++i) lb.store(i, kt + 1, rb[i], Bs);
            __syncthreads();
        }
    }
    epi(acc, wr, wc, fr, fq);
}

constexpr int KVBLK = 64;
constexpr int SHM_V = KVBLK * 128 * 2, SHM_K = KVBLK * 64 * 2;
constexpr int ATT_LDS = 2 * SHM_V + 2 * SHM_K + 8 * 64 * 4;
constexpr float ATT_THR = 8.f * 1.4426950408889634f;
#define KSWZ64(row, colB) ((row) * 128 + ((colB) ^ ((((row) >> 1) & 7) << 4)))
#define SBAR() __builtin_amdgcn_sched_barrier(0)
__device__ __forceinline__ int crow(int r, int hi) { return (r & 3) + 8 * (r >> 2) + 4 * hi; }

__device__ __forceinline__ void partialSM(f32x16& p0, f32x16& p1, float& m_reg, float& mn, float& alpha) {
    float pmax = p0[0];
#pragma unroll
    for (int r = 1; r < 16; ++r) pmax = fmaxf(pmax, p0[r]);
#pragma unroll
    for (int r = 0; r < 16; ++r) pmax = fmaxf(pmax, p1[r]);
    { auto rr = __builtin_amdgcn_permlane32_swap(__float_as_uint(pmax), __float_as_uint(pmax), false, false);
      pmax = fmaxf(__uint_as_float(rr[0]), __uint_as_float(rr[1])); }
    if (__builtin_expect(__all(pmax - m_reg <= ATT_THR), 1)) { mn = m_reg; alpha = 1.f; }
    else { mn = fmaxf(m_reg, pmax); alpha = __builtin_amdgcn_exp2f(m_reg - mn); m_reg = mn; }
#pragma unroll
    for (int r = 0; r < 16; ++r) p0[r] = p0[r] - mn;
#pragma unroll
    for (int r = 0; r < 16; ++r) p1[r] = p1[r] - mn;
#pragma unroll
    for (int r = 0; r < 16; ++r) p0[r] = __builtin_amdgcn_exp2f(p0[r]);
}
__device__ __forceinline__ void finishSM(f32x16& p0, f32x16& p1, float alpha, float& l_reg, bf16x8& pa0, bf16x8& pa1, bf16x8& pa2, bf16x8& pa3) {
#pragma unroll
    for (int r = 0; r < 16; ++r) p1[r] = __builtin_amdgcn_exp2f(p1[r]);
    float ps = 0;
#pragma unroll
    for (int r = 0; r < 16; ++r) ps += p0[r];
#pragma unroll
    for (int r = 0; r < 16; ++r) ps += p1[r];
    { auto rr = __builtin_amdgcn_permlane32_swap(__float_as_uint(ps), __float_as_uint(ps), false, false);
      ps = __uint_as_float(rr[0]) + __uint_as_float(rr[1]); }
    l_reg = l_reg * alpha + ps;
#define PK4(P, BASE, OUT) do { unsigned a0 = cvt_pk_bf16(P[BASE + 0], P[BASE + 1]), a1 = cvt_pk_bf16(P[BASE + 2], P[BASE + 3]);   \
    unsigned b0 = cvt_pk_bf16(P[BASE + 4], P[BASE + 5]), b1 = cvt_pk_bf16(P[BASE + 6], P[BASE + 7]);                              \
    auto r0 = __builtin_amdgcn_permlane32_swap(a0, b0, false, false); auto r1 = __builtin_amdgcn_permlane32_swap(a1, b1, false, false); \
    u32x4 w = {r0[0], r1[0], r0[1], r1[1]}; OUT = *reinterpret_cast<bf16x8*>(&w); } while (0)
    PK4(p0, 0, pa0); PK4(p0, 8, pa1); PK4(p1, 0, pa2); PK4(p1, 8, pa3);
#undef PK4
}
__device__ __forceinline__ void qkt(f32x16& p0, f32x16& p1, const LAS unsigned char* Ks, const bf16x8* qr, int r32, int hi) {
    p0 = f32x16{}; p1 = f32x16{};
#pragma unroll
    for (int d0 = 0; d0 < 4; ++d0) { const int cb = (d0 * 16 + hi * 8) * 2;
        bf16x8 b0 = *(const LAS bf16x8*)(Ks + KSWZ64(r32, cb));
        bf16x8 b1 = *(const LAS bf16x8*)(Ks + KSWZ64(32 + r32, cb));
        p0 = __builtin_amdgcn_mfma_f32_32x32x16_bf16(b0, qr[d0], p0, 0, 0, 0);
        p1 = __builtin_amdgcn_mfma_f32_32x32x16_bf16(b1, qr[d0], p1, 0, 0, 0); }
}
__device__ __forceinline__ int v_st(int k, int c) { const int kk = (k & ~0xC) | ((k & 4) << 1) | ((k & 8) >> 1); return ((kk >> 3) * 4 + (c >> 5)) * 512 + ((kk & 7) * 32 + (c & 31)) * 2; }
__device__ __forceinline__ int v_rd_base(int lane) { return ((lane & 3) << 3) | (((lane >> 2) & 3) << 6) | (((lane >> 4) & 1) << 5) | (((lane >> 5) & 1) << 8); }
constexpr int v_rd_off(int d0, int ks, int half) { return d0 * 512 + ks * 4096 + half * 2048; }
template <int OFF> __device__ __forceinline__ s16x4 tr_read(int vb) {
    s16x4 r; asm volatile("ds_read_b64_tr_b16 %0, %1 offset:%2" : "=&v"(r) : "v"(vb), "i"(OFF) : "memory"); return r;
}
template <int D0> __device__ __forceinline__ void pv_one(f32x16& od, int vb, bf16x8 pa0, bf16x8 pa1, bf16x8 pa2, bf16x8 pa3) {
    const s16x4 l0 = tr_read<v_rd_off(D0, 0, 0)>(vb), h0 = tr_read<v_rd_off(D0, 0, 1)>(vb), l1 = tr_read<v_rd_off(D0, 1, 0)>(vb), h1 = tr_read<v_rd_off(D0, 1, 1)>(vb);
    const s16x4 l2 = tr_read<v_rd_off(D0, 2, 0)>(vb), h2 = tr_read<v_rd_off(D0, 2, 1)>(vb), l3 = tr_read<v_rd_off(D0, 3, 0)>(vb), h3 = tr_read<v_rd_off(D0, 3, 1)>(vb);
    asm volatile("s_waitcnt lgkmcnt(0)" ::: "memory"); SBAR();
#define PK(L, H) (bf16x8){L[0], L[1], L[2], L[3], H[0], H[1], H[2], H[3]}
    od = __builtin_amdgcn_mfma_f32_32x32x16_bf16(pa0, PK(l0, h0), od, 0, 0, 0);
    od = __builtin_amdgcn_mfma_f32_32x32x16_bf16(pa1, PK(l1, h1), od, 0, 0, 0);
    od = __builtin_amdgcn_mfma_f32_32x32x16_bf16(pa2, PK(l2, h2), od, 0, 0, 0);
    od = __builtin_amdgcn_mfma_f32_32x32x16_bf16(pa3, PK(l3, h3), od, 0, 0, 0);
#undef PK
}
__device__ __forceinline__ void pv_d0(f32x16* o, int vb, bf16x8 pa0, bf16x8 pa1, bf16x8 pa2, bf16x8 pa3) {
    pv_one<0>(o[0], vb, pa0, pa1, pa2, pa3); pv_one<1>(o[1], vb, pa0, pa1, pa2, pa3); pv_one<2>(o[2], vb, pa0, pa1, pa2, pa3); pv_one<3>(o[3], vb, pa0, pa1, pa2, pa3);
}
__device__ __forceinline__ void attn_map(const bf16_t* __restrict__ Qb, const bf16_t* __restrict__ Kh, const bf16_t* __restrict__ Vh, LAS unsigned char* lds, f32x16 (&o)[4]) {
    const int tid = threadIdx.x, wid = tid >> 6, lane = tid & 63, r32 = lane & 31, hi = lane >> 5;
    LAS unsigned char* V_lds = lds; LAS unsigned char* K_lds = lds + 2 * SHM_V;
    LAS float* wsx = (LAS float*)(lds + 2 * SHM_V + 2 * SHM_K) + wid * 64; LAS float* li_l = wsx; LAS float* al_l = wsx + 32;
    float m_reg = -1e30f, l_reg = 0; bf16x8 qr[4];
#pragma unroll
    for (int d = 0; d < 4; ++d) o[d] = f32x16{};
    const bf16_t* Qw = Qb + (size_t)(wid * 32 + r32) * INC + hi * 8;
#pragma unroll
    for (int d0 = 0; d0 < 4; ++d0) qr[d0] = *(const bf16x8*)(Qw + d0 * 16);
    const int sr = tid >> 4, sc = (tid & 15) * 8, vst0 = v_st(sr, sc), vst1 = v_st(32 + sr, sc);
    const int ksr = tid >> 3, ksc = (tid & 7) * 8, kst = KSWZ64(ksr, ksc * 2);
    const int vb0 = (int)(uintptr_t)V_lds + v_rd_base(lane);
    struct { bf16x8 vs0, vs1, ks0; } sr_[2];
#define SLOAD(i, k0) do { sr_[i].vs0 = *(const bf16x8*)(&Vh[(size_t)((k0) + sr) * INC + sc]); sr_[i].vs1 = *(const bf16x8*)(&Vh[(size_t)((k0) + 32 + sr) * INC + sc]); \
    sr_[i].ks0 = *(const bf16x8*)(&Kh[(size_t)((k0) + ksr) * INC + ksc]); } while (0)
#define SWRITE(b, i) do { *(LAS bf16x8*)(V_lds + (b) * SHM_V + vst0) = sr_[i].vs0; *(LAS bf16x8*)(V_lds + (b) * SHM_V + vst1) = sr_[i].vs1; \
    *(LAS bf16x8*)(K_lds + (b) * SHM_K + kst) = sr_[i].ks0; } while (0)
#define SWAIT() asm volatile("s_waitcnt vmcnt(3)" ::: "memory")
#define RESC(a) do { if (__any((a) < 1.f)) { if (hi == 0) al_l[r32] = (a); asm volatile("s_waitcnt lgkmcnt(0)" ::: "memory"); \
    _Pragma("unroll") for (int d = 0; d < 4; ++d) _Pragma("unroll") for (int r = 0; r < 16; ++r) o[d][r] *= al_l[crow(r, hi)]; } } while (0)
    f32x16 pA0, pA1, pB0, pB1; float mnA, mnB, alA, alB; bf16x8 pa0, pa1, pa2, pa3; const int NT = SEQ / KVBLK;
    constexpr int SE = 0, SO = 1;
    __syncthreads();
    SLOAD(SE, 0); asm volatile("s_waitcnt vmcnt(0)" ::: "memory"); SWRITE(0, SE); __syncthreads();
    qkt(pA0, pA1, K_lds, qr, r32, hi); partialSM(pA0, pA1, m_reg, mnA, alA);
    SLOAD(SO, KVBLK); SLOAD(SE, 2 * KVBLK);
    SWAIT(); SWRITE(1, SO); __syncthreads();
    for (int j = 1; j + 1 < NT; j += 2) {
        SBAR(); qkt(pB0, pB1, K_lds + SHM_K, qr, r32, hi);
        finishSM(pA0, pA1, alA, l_reg, pa0, pa1, pa2, pa3); SBAR();
        SLOAD(SO, (j + 2) * KVBLK); SBAR();
        pv_d0(o, vb0, pa0, pa1, pa2, pa3); partialSM(pB0, pB1, m_reg, mnB, alB);
        __syncthreads(); SWAIT(); SWRITE(0, SE);
        RESC(alB); __syncthreads();
        SBAR(); qkt(pA0, pA1, K_lds, qr, r32, hi);
        finishSM(pB0, pB1, alB, l_reg, pa0, pa1, pa2, pa3); SBAR();
        if (j + 3 < NT) SLOAD(SE, (j + 3) * KVBLK); SBAR();
        pv_d0(o, vb0 + SHM_V, pa0, pa1, pa2, pa3); partialSM(pA0, pA1, m_reg, mnA, alA);
        __syncthreads(); SWAIT(); SWRITE(1, SO);
        RESC(alA); __syncthreads();
    }
    SBAR(); qkt(pB0, pB1, K_lds + SHM_K, qr, r32, hi);
    finishSM(pA0, pA1, alA, l_reg, pa0, pa1, pa2, pa3); SBAR();
    pv_d0(o, vb0, pa0, pa1, pa2, pa3); partialSM(pB0, pB1, m_reg, mnB, alB);
    __syncthreads(); RESC(alB);
    finishSM(pB0, pB1, alB, l_reg, pa0, pa1, pa2, pa3); SBAR();
    pv_d0(o, vb0 + SHM_V, pa0, pa1, pa2, pa3);
    if (hi == 0) li_l[r32] = l_reg; asm volatile("s_waitcnt lgkmcnt(0)" ::: "memory");
#pragma unroll
    for (int r = 0; r < 16; ++r) { const float rl = __builtin_amdgcn_rcpf(li_l[crow(r, hi)]);
#pragma unroll
        for (int d = 0; d < 4; ++d) o[d][r] *= rl; }
#undef SLOAD
#undef SWRITE
#undef SWAIT
#undef RESC
}

__device__ __forceinline__ f32x2 cmul(f32x2 a, f32x2 b) { return (f32x2){a.x * b.x - a.y * b.y, a.x * b.y + a.y * b.x}; }
__device__ __forceinline__ f32x2 cmulc(f32x2 a, f32x2 b) { return (f32x2){a.x * b.x + a.y * b.y, a.y * b.x - a.x * b.y}; }
__device__ __forceinline__ int rev4_14(int k) { unsigned x = __brev((unsigned)k) >> 18; return (int)(((x & 0x2AAAu) >> 1) | ((x & 0x1555u) << 1)); }
__device__ __forceinline__ void fft_pass_fwd(LAS f32x2* Z, const f32x2* __restrict__ tw, int ln, int tid) {
    const int lq = ln - 2, q = 1 << lq, ts = 14 - ln;
#pragma unroll 2
    for (int i = 0; i < 8; ++i) {
        const int bi = tid + 512 * i, j = bi & (q - 1), base = ((bi >> lq) << ln) + j;
        const f32x2 a0 = Z[base], a1 = Z[base + q], a2 = Z[base + 2 * q], a3 = Z[base + 3 * q];
        const f32x2 w1 = tw[j << ts], w2 = tw[(2 * j) << ts], w3 = tw[(3 * j) << ts];
        const f32x2 s02 = a0 + a2, d02 = a0 - a2, s13 = a1 + a3, d13 = a1 - a3;
        const f32x2 b0 = s02 + s13, b2 = s02 - s13;
        const f32x2 b1 = (f32x2){d02.x + d13.y, d02.y - d13.x};
        const f32x2 b3 = (f32x2){d02.x - d13.y, d02.y + d13.x};
        Z[base] = b0; Z[base + q] = cmul(b1, w1); Z[base + 2 * q] = cmul(b2, w2); Z[base + 3 * q] = cmul(b3, w3);
    }
}
__device__ __forceinline__ void fft_pass_inv(LAS f32x2* Z, const f32x2* __restrict__ tw, int ln, int tid) {
    const int lq = ln - 2, q = 1 << lq, ts = 14 - ln;
#pragma unroll 2
    for (int i = 0; i < 8; ++i) {
        const int bi = tid + 512 * i, j = bi & (q - 1), base = ((bi >> lq) << ln) + j;
        const f32x2 w1 = tw[j << ts], w2 = tw[(2 * j) << ts], w3 = tw[(3 * j) << ts];
        const f32x2 c0 = Z[base], c1 = cmulc(Z[base + q], w1), c2 = cmulc(Z[base + 2 * q], w2), c3 = cmulc(Z[base + 3 * q], w3);
        const f32x2 s02 = c0 + c2, d02 = c0 - c2, s13 = c1 + c3, d13 = c1 - c3;
        Z[base] = s02 + s13; Z[base + 2 * q] = s02 - s13;
        Z[base + q] = (f32x2){d02.x - d13.y, d02.y + d13.x};
        Z[base + 3 * q] = (f32x2){d02.x + d13.y, d02.y - d13.x};
    }
}
__device__ __forceinline__ void fft_fwd(LAS f32x2* Z, const f32x2* tw, int tid) {
    for (int ln = 14; ln >= 2; ln -= 2) { fft_pass_fwd(Z, tw, ln, tid); __syncthreads(); }
}
__device__ __forceinline__ void fft_inv(LAS f32x2* Z, const f32x2* tw, int tid) {
    for (int ln = 2; ln <= 14; ln += 2) { fft_pass_inv(Z, tw, ln, tid); __syncthreads(); }
}

struct Args { const void* in[34]; float* out; unsigned char* ws; int ph_lo, ph_hi; };

#define INF(i) ((const float*)args.in[i])

__global__ void __launch_bounds__(512, 2) mk_fwd(Args args) {
    extern __shared__ __attribute__((aligned(16))) unsigned char lds_raw[];
    LAS unsigned char* lds = (LAS unsigned char*)lds_raw;
    volatile LAS unsigned* MISC = (volatile LAS unsigned*)(lds + LDS_MISC);
    const int tid = threadIdx.x, lane = tid & 63, wid = __builtin_amdgcn_readfirstlane(tid >> 6);
    const int G = gridDim.x, bid = blockIdx.x;
    unsigned char* ws = args.ws;
    unsigned* ctl = (unsigned*)(ws + WS_CTL);
    unsigned* ecnt = (unsigned*)(ws + WS_CTL + CTL_CNT_OFF);
    if (tid < 64) MISC[tid] = 0u;
    __syncthreads();
    XcdBarrier bar; bar.bar = ctl; bar.x = 0; bar.st = MISC;
    if (MK_LAUNCHES == 1) bar = xcd_barrier_post(ctl, MISC);
    const int lo = args.ph_lo, hi_ph = args.ph_hi;
#define IN_PH(k) (((PH_MASK >> (k)) & 1) && (DEBUG_TAP < 0 || (k) <= DEBUG_TAP) && lo <= (k) && (k) < hi_ph)
#define SEAM(k) do { if (IN_PH((k) + 1)) { if (MK_LAUNCHES == 1) xcd_barrier(bar); } } while (0)

    bf16_t* H0B = (bf16_t*)(ws + WS_H0B); bf16_t* PROJ = (bf16_t*)(ws + WS_PROJ); bf16_t* X0 = (bf16_t*)(ws + WS_X0);
    float* VXT = (float*)(ws + WS_VXT); float* YT = (float*)(ws + WS_YT); float* HFILT = (float*)(ws + WS_HFILT);
    f32x2* TW = (f32x2*)(ws + WS_TW); bf16_t* CONCAT = (bf16_t*)(ws + WS_CONCAT); bf16_t* YSLOTS = (bf16_t*)(ws + WS_YSLOTS);
    float* ASCR = (float*)(ws + WS_ASCR); f32x2* GS = (f32x2*)(ws + WS_GS); float* R1 = (float*)(ws + WS_R1);
    float* H1F = (float*)(ws + WS_H1F); bf16_t* H1B = (bf16_t*)(ws + WS_H1B); float* LOGITS = (float*)(ws + WS_LOGITS);
    bf16_t* HS = (bf16_t*)(ws + WS_HS); bf16_t* HEXP = (bf16_t*)(ws + WS_HEXP); float* YSH = (float*)(ws + WS_YSH);
    int* LISTS = (int*)(ws + WS_LISTS); float* GATES = (float*)(ws + WS_GATES);

    if (IN_PH(0)) {
        { const float* x = INF(0); const float* g = INF(2); const float* bta = INF(3);
          for (int row = bid * 8 + wid; row < T; row += G * 8) {
              const f32x4* xr = (const f32x4*)(x + (size_t)row * DM);
              f32x4 v[4]; float s = 0.f;
#pragma unroll
              for (int i = 0; i < 4; ++i) { v[i] = xr[lane + 64 * i]; s += (v[i][0] + v[i][1]) + (v[i][2] + v[i][3]); }
              const float mean = wave_sum(s) * (1.f / DM); float q = 0.f;
#pragma unroll
              for (int i = 0; i < 4; ++i) { const f32x4 d = v[i] - mean; q += (d[0] * d[0] + d[1] * d[1]) + (d[2] * d[2] + d[3] * d[3]); }
              const float rstd = rsqrtf(wave_sum(q) * (1.f / DM) + LN_EPS);
#pragma unroll
              for (int i = 0; i < 4; ++i) { const int c = (lane + 64 * i) * 4; const f32x4 gg = *(const f32x4*)(g + c), bb = *(const f32x4*)(bta + c);
                  const f32x4 y = (v[i] - mean) * rstd * gg + bb; u32x2 w; w.x = cvt_pk_bf16(y[0], y[1]); w.y = cvt_pk_bf16(y[2], y[3]);
                  *(u32x2*)(H0B + (size_t)row * DM + c) = w; }
          } }
        for (int j = bid * 512 + tid; j < NFFT; j += G * 512) { float s, c; sincospif((float)j * (1.0f / 8192.0f), &s, &c); TW[j] = (f32x2){c, -s}; }
        { const float* w1 = INF(7); const float* b1 = INF(8); const float* w2 = INF(9); const float* b2 = INF(10); const float* w3 = INF(11); const float* b3 = INF(12);
          const float* freq = INF(13); const float* wout = INF(14);
          LAS float* zz = (LAS float*)lds;
          LAS float* ha = zz + 32 * 36;
          LAS float* hb = ha + 32 * 64;
          LAS float* h3t = hb + 32 * 64;
          for (int tb = bid; tb < SEQ / 32; tb += G) {
              const int t0 = tb * 32;
              __syncthreads();
              { const int tl = tid >> 4, j = tid & 15, t = t0 + tl;
                const float wt = 6.283185307179586f * (float)t / (float)SEQ;
                const float f = 1e-4f + (float)j * ((15.0f - 1e-4f) / 15.0f);
                float s, c; sincosf(f * wt, &s, &c);
                zz[tl * 36 + 1 + j] = c; zz[tl * 36 + 17 + j] = -s;
                if (j == 0) zz[tl * 36] = (float)t / (float)(SEQ - 1); }
              __syncthreads();
              { const int tl = tid >> 4, o4 = (tid & 15) * 4;
                float a[4];
#pragma unroll
                for (int e = 0; e < 4; ++e) a[e] = b1[o4 + e];
#pragma unroll 3
                for (int i = 0; i < 33; ++i) { const float zv = zz[tl * 36 + i];
#pragma unroll
                    for (int e = 0; e < 4; ++e) a[e] += zv * w1[i * 64 + o4 + e]; }
#pragma unroll
                for (int e = 0; e < 4; ++e) ha[tl * 64 + o4 + e] = sinf(freq[o4 + e] * a[e]); }
              __syncthreads();
              { const int tl = tid >> 4, o4 = (tid & 15) * 4;
                float a[4];
#pragma unroll
                for (int e = 0; e < 4; ++e) a[e] = b2[o4 + e];
#pragma unroll 4
                for (int i = 0; i < 64; ++i) { const float zv = ha[tl * 64 + i];
#pragma unroll
                    for (int e = 0; e < 4; ++e) a[e] += zv * w2[i * 64 + o4 + e]; }
#pragma unroll
                for (int e = 0; e < 4; ++e) hb[tl * 64 + o4 + e] = sinf(freq[64 + o4 + e] * a[e]); }
              __syncthreads();
              { const int tl = tid >> 4, o4 = (tid & 15) * 4;
                float a[4];
#pragma unroll
                for (int e = 0; e < 4; ++e) a[e] = b3[o4 + e];
#pragma unroll 4
                for (int i = 0; i < 64; ++i) { const float zv = hb[tl * 64 + i];
#pragma unroll
                    for (int e = 0; e < 4; ++e) a[e] += zv * w3[i * 64 + o4 + e]; }
#pragma unroll
                for (int e = 0; e < 4; ++e) h3t[(o4 + e) * 32 + tl] = sinf(freq[128 + o4 + e] * a[e]); }
              __syncthreads();
#pragma unroll 1
              for (int cc = 0; cc < 2; ++cc) {
                  const int col = tid + 512 * cc;
                  float acc[32];
#pragma unroll
                  for (int e = 0; e < 32; ++e) acc[e] = 0.f;
#pragma unroll 2
                  for (int k = 0; k < 64; ++k) { const float w = wout[(size_t)k * 1024 + col];
#pragma unroll
                      for (int e4 = 0; e4 < 8; ++e4) { const f32x4 hv = *(const LAS f32x4*)(h3t + k * 32 + e4 * 4);
                          acc[e4 * 4 + 0] += hv[0] * w; acc[e4 * 4 + 1] += hv[1] * w; acc[e4 * 4 + 2] += hv[2] * w; acc[e4 * 4 + 3] += hv[3] * w; } }
                  const int c = col & 511;
                  const float dl0 = 3.0701134573253943f, dl1 = 15.350567286626971f;
                  const float delta = dl0 + (float)c * ((dl1 - dl0) / 511.0f);
#pragma unroll
                  for (int e4 = 0; e4 < 8; ++e4) { f32x4 o;
#pragma unroll
                      for (int e = 0; e < 4; ++e) { const float tl = (float)(t0 + e4 * 4 + e) / (float)(SEQ - 1); o[e] = acc[e4 * 4 + e] * expf(-tl * delta); }
                      *(f32x4*)(HFILT + (size_t)col * SEQ + t0 + e4 * 4) = o; }
              }
          } }
        SEAM(0);
    }

    if (IN_PH(1)) {
        const float* w_in = INF(4);
        for (int u = bid; u < (T / 256) * (INC / 128); u += G) {
            const int pn = u % (INC / 128), pm = u / (INC / 128);
            LdBf16<4> la; la.base = (const unsigned char*)H0B; la.ldsoff = (tid >> 3) * LDT + (tid & 7) * 16;
#pragma unroll
            for (int i = 0; i < 4; ++i) la.off[i] = (unsigned)(((pm * 256 + (tid >> 3) + 64 * i) * DM + (tid & 7) * 8) * 2);
            LdF32KN<128, false> lb; const int n = tid & 127, kc0 = tid >> 7;
            lb.p = w_in + (size_t)(kc0 * 8) * INC + pn * 128 + n; lb.N = INC; lb.scale = (pn * 128 < 512) ? QSCALE : 1.f; lb.kc0 = kc0; lb.ldsoff = n * LDT + kc0 * 16;
            auto epi = [&](const f32x4 (&acc)[4][4], int wr, int wc, int fr, int fq) {
#pragma unroll
                for (int m = 0; m < 4; ++m)
#pragma unroll
                    for (int nn = 0; nn < 4; ++nn)
#pragma unroll
                        for (int j = 0; j < 4; ++j) {
                            const int row = pm * 256 + wr * 64 + m * 16 + fq * 4 + j, col = pn * 128 + wc * 64 + nn * 16 + fr;
                            PROJ[(size_t)row * INC + col] = f2bf(acc[m][nn][j]); }
            };
            gemm_tile<256, 128>(lds, la, lb, DM / 64, epi);
        }
        SEAM(1);
    }

    if (IN_PH(2)) {
        const int* pos = (const int*)args.in[1]; const float* cw = INF(5); const float* cb = INF(6);
        LAS float* tile = (LAS float*)lds;
        for (int tb = bid; tb < T / 64; tb += G) {
            const int row0 = tb * 64, b = tb / (SEQ / 64), l0 = (tb % (SEQ / 64)) * 64;
            __syncthreads();
#pragma unroll 2
            for (int i = 0; i < 16; ++i) {
                const int it = tid + 512 * i, i8 = it & 7, mp = (it >> 3) & 7, qk = (it >> 6) & 1, r = it >> 7;
                bf16_t* p = PROJ + (size_t)(row0 + r) * INC + qk * 512 + mp * 64 + i8;
                const float t1 = bf2f(p[0]), t2 = bf2f(p[8]);
                const float invf = exp2f(-(float)i8 * (18.931568569324174f / 8.0f));
                const float ang = (float)pos[row0 + r] * invf;
                float s, c; sincosf(ang, &s, &c);
                p[0] = f2bf(t1 * c - t2 * s); p[8] = f2bf(t2 * c + t1 * s);
            }
            { const int c8 = lane, ch = c8 * 8;
              float w0[3][8], w1[3][8], w2[3][8], bb[3][8];
#pragma unroll
              for (int part = 0; part < 3; ++part)
#pragma unroll
                  for (int e = 0; e < 8; ++e) { const int cidx = part * CH + ch + e;
                      w0[part][e] = cw[cidx]; w1[part][e] = cw[3 * CH + cidx]; w2[part][e] = cw[6 * CH + cidx]; bb[part][e] = cb[cidx]; }
#pragma unroll 1
              for (int tt = 0; tt < 8; ++tt) {
                  const int t = wid * 8 + tt, l = l0 + t;
                  float y[3][8];
#pragma unroll
                  for (int part = 0; part < 3; ++part) {
                      const bf16_t* up = PROJ + (size_t)(row0 + t) * INC + 1536 + part * CH + ch;
                      const u32x4 cu = *(const u32x4*)up;
                      u32x4 pu = (u32x4){0u, 0u, 0u, 0u}, nu = (u32x4){0u, 0u, 0u, 0u};
                      if (l > 0) pu = *(const u32x4*)(up - INC);
                      if (l < SEQ - 1) nu = *(const u32x4*)(up + INC);
#pragma unroll
                      for (int e2 = 0; e2 < 4; ++e2) {
                          y[part][2 * e2] = bb[part][2 * e2] + w0[part][2 * e2] * bflo(pu[e2]) + w1[part][2 * e2] * bflo(cu[e2]) + w2[part][2 * e2] * bflo(nu[e2]);
                          y[part][2 * e2 + 1] = bb[part][2 * e2 + 1] + w0[part][2 * e2 + 1] * bfhi(pu[e2]) + w1[part][2 * e2 + 1] * bfhi(cu[e2]) + w2[part][2 * e2 + 1] * bfhi(nu[e2]);
                      }
                  }
                  u32x4 xo; xo.x = cvt_pk_bf16(y[0][0], y[0][1]); xo.y = cvt_pk_bf16(y[0][2], y[0][3]); xo.z = cvt_pk_bf16(y[0][4], y[0][5]); xo.w = cvt_pk_bf16(y[0][6], y[0][7]);
                  *(u32x4*)(X0 + (size_t)(row0 + t) * CH + ch) = xo;
#pragma unroll
                  for (int e = 0; e < 8; ++e) tile[(ch + e) * 65 + t] = y[2][e] * y[1][e];
              } }
            __syncthreads();
#pragma unroll 2
            for (int i = 0; i < 16; ++i) {
                const int it = tid + 512 * i, c = it >> 4, q4 = it & 15;
                f32x4 v; v[0] = tile[c * 65 + q4 * 4]; v[1] = tile[c * 65 + q4 * 4 + 1]; v[2] = tile[c * 65 + q4 * 4 + 2]; v[3] = tile[c * 65 + q4 * 4 + 3];
                *(f32x4*)(VXT + ((size_t)(b * CH + c)) * SEQ + l0 + q4 * 4) = v;
            }
        }
        SEAM(2);
    }

    if (IN_PH(3)) {
        for (int u = bid; u < CH / 2; u += G) {
            const int c0 = 2 * u;
            LAS f32x2* Z = (LAS f32x2*)lds;
            LAS float* red = (LAS float*)(lds + 131072);
            __syncthreads();
            float sa = 0.f, sb = 0.f;
            { const float* fa = HFILT + (size_t)c0 * SEQ; const float* fb = HFILT + (size_t)(c0 + 1) * SEQ;
              const float* ba = HFILT + (size_t)(CH + c0) * SEQ; const float* bb = HFILT + (size_t)(CH + c0 + 1) * SEQ;
              for (int t = tid; t < SEQ; t += 512) {
                  const float xa = fa[t], xb = fb[t]; Z[t] = (f32x2){xa, xb}; sa += fabsf(xa); sb += fabsf(xb);
                  if (t == 0) Z[SEQ] = (f32x2){0.f, 0.f};
                  else { const float ya = ba[t], yb = bb[t]; Z[2 * SEQ - t] = (f32x2){ya, yb}; sa += fabsf(ya); sb += fabsf(yb); }
              } }
            sa = wave_sum(sa); sb = wave_sum(sb);
            if (lane == 0) { red[wid] = sa; red[8 + wid] = sb; }
            __syncthreads();
            float ta = 0.f, tb2 = 0.f;
#pragma unroll
            for (int w = 0; w < 8; ++w) { ta += red[w]; tb2 += red[8 + w]; }
            const float isa = 1.f / ta, isb = 1.f / tb2;
            fft_fwd(Z, TW, tid);
            f32x2* Gs = GS + (size_t)u * NFFT;
            for (int p = tid; p < NFFT; p += 512) Gs[p] = Z[p];
            asm volatile("s_waitcnt vmcnt(0)" ::: "memory");
            __syncthreads();
            const float da = INF(15)[c0], db = INF(15)[c0 + 1];
#pragma unroll 1
            for (int b = 0; b < NBATCH; ++b) {
                const float* va = VXT + ((size_t)(b * CH + c0)) * SEQ; const float* vb = va + SEQ;
                for (int t = tid; t < SEQ; t += 512) { Z[t] = (f32x2){va[t], vb[t]}; Z[SEQ + t] = (f32x2){0.f, 0.f}; }
                __syncthreads();
                fft_fwd(Z, TW, tid);
                for (int k = tid; k <= NFFT / 2; k += 512) {
                    const int p = rev4_14(k), pp = rev4_14((NFFT - k) & (NFFT - 1));
                    const f32x2 Gk = Gs[p], Gn = Gs[pp], Zk = Z[p], Zn = Z[pp];
                    const f32x2 Ha = (f32x2){(Gk.x + Gn.x) * 0.5f * isa, (Gk.y - Gn.y) * 0.5f * isa};
                    const f32x2 Hb = (f32x2){(Gk.y + Gn.y) * 0.5f * isb, -(Gk.x - Gn.x) * 0.5f * isb};
                    const f32x2 A = (f32x2){(Zk.x + Zn.x) * 0.5f, (Zk.y - Zn.y) * 0.5f};
                    const f32x2 B = (f32x2){(Zk.y + Zn.y) * 0.5f, -(Zk.x - Zn.x) * 0.5f};
                    const f32x2 Pa = cmul(A, Ha), Pb = cmul(B, Hb);
                    Z[p] = (f32x2){Pa.x - Pb.y, Pa.y + Pb.x};
                    if (pp != p) Z[pp] = (f32x2){Pa.x + Pb.y, -Pa.y + Pb.x};
                }
                __syncthreads();
                fft_inv(Z, TW, tid);
                float* ya = YT + ((size_t)(b * CH + c0)) * SEQ; float* yb = ya + SEQ;
                for (int t = tid; t < SEQ; t += 512) { const f32x2 z = Z[t]; ya[t] = z.x * (1.f / NFFT) + va[t] * da; yb[t] = z.y * (1.f / NFFT) + vb[t] * db; }
                __syncthreads();
            }
        }
        { float lam;
          { const float* q1 = INF(16); const float* k1 = INF(17); const float* q2 = INF(18); const float* k2 = INF(19);
            float s1 = 0.f, s2 = 0.f;
            for (int i = 0; i < 64; ++i) { s1 += q1[i] * k1[i]; s2 += q2[i] * k2[i]; }
            lam = expf(s1) - expf(s2) + 0.2f; }
          const float* subg = INF(20);
          float* scr = ASCR + (size_t)bid * 32768;
          const int r32 = lane & 31, hi = lane >> 5;
          for (int u = bid; u < NBATCH * 4 * (SEQ / 256); u += G) {
              const int qb = u % (SEQ / 256), h = (u / (SEQ / 256)) % 4, b = u / (4 * (SEQ / 256));
              const size_t rowb = (size_t)b * SEQ;
              f32x16 o[4];
#pragma unroll 1
              for (int c = 0; c < 2; ++c) {
                  const bf16_t* Qb = PROJ + (rowb + (size_t)qb * 256) * INC + h * 128 + c * 64;
                  const bf16_t* Kh = PROJ + rowb * INC + 512 + h * 128 + c * 64;
                  const bf16_t* Vh = PROJ + rowb * INC + 1024 + h * 128;
                  attn_map(Qb, Kh, Vh, lds, o);
                  if (c == 0) {
                      float* st = scr + tid * 64;
#pragma unroll
                      for (int d = 0; d < 4; ++d)
#pragma unroll
                          for (int r4 = 0; r4 < 4; ++r4) *(f32x4*)(st + d * 16 + r4 * 4) = (f32x4){o[d][r4 * 4], o[d][r4 * 4 + 1], o[d][r4 * 4 + 2], o[d][r4 * 4 + 3]};
                  }
              }
              asm volatile("s_waitcnt vmcnt(0)" ::: "memory");
              float ss[16];
#pragma unroll
              for (int r = 0; r < 16; ++r) ss[r] = 0.f;
              { const float* st = scr + tid * 64;
#pragma unroll
              for (int d = 0; d < 4; ++d)
#pragma unroll
                  for (int r4 = 0; r4 < 4; ++r4) { const f32x4 o1 = *(const f32x4*)(st + d * 16 + r4 * 4);
#pragma unroll
                      for (int e = 0; e < 4; ++e) { const int r = r4 * 4 + e; const float x = o1[e] - lam * o[d][r]; o[d][r] = x; ss[r] += x * x; } } }
#pragma unroll
              for (int r = 0; r < 16; ++r) {
#pragma unroll
                  for (int m = 16; m >= 1; m >>= 1) ss[r] += __shfl_xor(ss[r], m);
                  ss[r] = rsqrtf(ss[r] * (1.f / 128.f) + LN_EPS) * 0.8f; }
              unsigned cbase = (unsigned)((rowb + (size_t)qb * 256 + (tid >> 6) * 32 + 4 * hi) * DM + h * 128 + r32);
              asm volatile("" : "+v"(cbase));
#pragma unroll
              for (int d = 0; d < 4; ++d) { const float gg = subg[d * 32 + r32];
#pragma unroll
                  for (int r = 0; r < 16; ++r)
                      CONCAT[cbase + (unsigned)(((r & 3) + 8 * (r >> 2)) * DM + d * 32)] = f2bf(o[d][r] * ss[r] * gg); }
          } }
        SEAM(3);
    }

    if (IN_PH(4)) {
        LAS float* tile = (LAS float*)lds;
        for (int tb = bid; tb < T / 64; tb += G) {
            const int row0 = tb * 64, b = tb / (SEQ / 64), l0 = (tb % (SEQ / 64)) * 64;
            __syncthreads();
#pragma unroll 2
            for (int i = 0; i < 16; ++i) {
                const int it = tid + 512 * i, c = it >> 4, q4 = it & 15;
                const f32x4 v = *(const f32x4*)(YT + ((size_t)(b * CH + c)) * SEQ + l0 + q4 * 4);
                tile[c * 65 + q4 * 4] = v[0]; tile[c * 65 + q4 * 4 + 1] = v[1]; tile[c * 65 + q4 * 4 + 2] = v[2]; tile[c * 65 + q4 * 4 + 3] = v[3];
            }
            __syncthreads();
#pragma unroll 1
            for (int tt = 0; tt < 8; ++tt) {
                const int t = wid * 8 + tt;
#pragma unroll
                for (int pp = 0; pp < 4; ++pp) {
                    const int c = 2 * (lane + 64 * pp);
                    const unsigned xw = *(const unsigned*)(X0 + (size_t)(row0 + t) * CH + c);
                    const float y0 = tile[c * 65 + t] * bflo(xw), y1 = tile[(c + 1) * 65 + t] * bfhi(xw);
                    *(unsigned*)(CONCAT + (size_t)(row0 + t) * DM + 512 + c) = cvt_pk_bf16(y0, y1);
                }
            }
        }
        SEAM(4);
    }

    if (IN_PH(5)) {
        const float* w_o = INF(21);
        for (int u = bid; u < (T / 256) * (DM / 128); u += G) {
            const int pn = u % (DM / 128), pm = u / (DM / 128);
            LdBf16<4> la; la.base = (const unsigned char*)CONCAT; la.ldsoff = (tid >> 3) * LDT + (tid & 7) * 16;
#pragma unroll
            for (int i = 0; i < 4; ++i) la.off[i] = (unsigned)(((pm * 256 + (tid >> 3) + 64 * i) * DM + (tid & 7) * 8) * 2);
            LdF32KN<128, false> lb; const int n = tid & 127, kc0 = tid >> 7;
            lb.p = w_o + (size_t)(kc0 * 8) * DM + pn * 128 + n; lb.N = DM; lb.scale = 1.f; lb.kc0 = kc0; lb.ldsoff = n * LDT + kc0 * 16;
            auto epi = [&](const f32x4 (&acc)[4][4], int wr, int wc, int fr, int fq) {
#pragma unroll
                for (int m = 0; m < 4; ++m)
#pragma unroll
                    for (int nn = 0; nn < 4; ++nn)
#pragma unroll
                        for (int j = 0; j < 4; ++j) {
                            const int row = pm * 256 + wr * 64 + m * 16 + fq * 4 + j, col = pn * 128 + wc * 64 + nn * 16 + fr;
                            R1[(size_t)row * DM + col] = ALPHA * bf2f(H0B[(size_t)row * DM + col]) + acc[m][nn][j]; }
            };
            gemm_tile<256, 128>(lds, la, lb, DM / 64, epi);
        }
        SEAM(5);
    }

    if (IN_PH(6)) {
        const float* g = INF(22); const float* bta = INF(23);
        for (int row = bid * 8 + wid; row < T; row += G * 8) {
            const f32x4* xr = (const f32x4*)(R1 + (size_t)row * DM);
            f32x4 v[4]; float s = 0.f;
#pragma unroll
            for (int i = 0; i < 4; ++i) { v[i] = xr[lane + 64 * i]; s += (v[i][0] + v[i][1]) + (v[i][2] + v[i][3]); }
            const float mean = wave_sum(s) * (1.f / DM); float q = 0.f;
#pragma unroll
            for (int i = 0; i < 4; ++i) { const f32x4 d = v[i] - mean; q += (d[0] * d[0] + d[1] * d[1]) + (d[2] * d[2] + d[3] * d[3]); }
            const float rstd = rsqrtf(wave_sum(q) * (1.f / DM) + LN_EPS);
#pragma unroll
            for (int i = 0; i < 4; ++i) { const int c = (lane + 64 * i) * 4; const f32x4 gg = *(const f32x4*)(g + c), bb = *(const f32x4*)(bta + c);
                const f32x4 y = (v[i] - mean) * rstd * gg + bb; u32x2 w; w.x = cvt_pk_bf16(y[0], y[1]); w.y = cvt_pk_bf16(y[2], y[3]);
                *(f32x4*)(H1F + (size_t)row * DM + c) = y; *(u32x2*)(H1B + (size_t)row * DM + c) = w; }
        }
        SEAM(6);
    }

    if (IN_PH(7)) {
        const float* w_r = INF(24);
        for (int u = bid; u < (T / 256) * (NE / 128); u += G) {
            const int pn = u % (NE / 128), pm = u / (NE / 128);
            LdF32Rows<4, true> la; la.base = (const unsigned char*)H1F; la.ldsoff = (tid >> 3) * LDT + (tid & 7) * 16;
#pragma unroll
            for (int i = 0; i < 4; ++i) la.off[i] = (unsigned)(((pm * 256 + (tid >> 3) + 64 * i) * DM + (tid & 7) * 8) * 4);
            LdF32KN<128, true> lb; const int n = tid & 127, kc0 = tid >> 7;
            lb.p = w_r + (size_t)(kc0 * 8) * NE + pn * 128 + n; lb.N = NE; lb.scale = 1.f; lb.kc0 = kc0; lb.ldsoff = n * LDT + kc0 * 16;
            auto epi = [&](const f32x4 (&acc)[4][4], int wr, int wc, int fr, int fq) {
#pragma unroll
                for (int m = 0; m < 4; ++m)
#pragma unroll
                    for (int nn = 0; nn < 4; ++nn)
#pragma unroll
                        for (int j = 0; j < 4; ++j) {
                            const int row = pm * 256 + wr * 64 + m * 16 + fq * 4 + j, col = pn * 128 + wc * 64 + nn * 16 + fr;
                            LOGITS[(size_t)row * NE + col] = acc[m][nn][j]; }
            };
            gemm_tile<256, 128>(lds, la, lb, 3 * DM / 64, epi);
        }
        const float* wsg = INF(29); const float* wsu = INF(30);
        for (int u = bid; u < (T / 256) * (ED / 64); u += G) {
            const int pn = u % (ED / 64), pm = u / (ED / 64);
            LdBf16<4> la; la.base = (const unsigned char*)H1B; la.ldsoff = (tid >> 3) * LDT + (tid & 7) * 16;
#pragma unroll
            for (int i = 0; i < 4; ++i) la.off[i] = (unsigned)(((pm * 256 + (tid >> 3) + 64 * i) * DM + (tid & 7) * 8) * 2);
            LdF32KN<128, false> lb; const int n = tid & 127, kc0 = tid >> 7;
            { const int q = n & 63, wcx = n >> 6; const float* src = (q < 32) ? wsg : wsu;
              lb.p = src + (size_t)(kc0 * 8) * ED + pn * 64 + wcx * 32 + (q & 31); }
            lb.N = ED; lb.scale = 1.f; lb.kc0 = kc0; lb.ldsoff = n * LDT + kc0 * 16;
            auto epi = [&](const f32x4 (&acc)[4][4], int wr, int wc, int fr, int fq) {
#pragma unroll
                for (int m = 0; m < 4; ++m)
#pragma unroll
                    for (int nn = 0; nn < 2; ++nn)
#pragma unroll
                        for (int j = 0; j < 4; ++j) {
                            const int row = pm * 256 + wr * 64 + m * 16 + fq * 4 + j, col = pn * 64 + wc * 32 + nn * 16 + fr;
                            const float gv = acc[m][nn][j], uv = acc[m][nn + 2][j];
                            const float hv = gv / (1.f + __expf(-gv)) * uv;
                            HS[(size_t)row * ED + col] = f2bf(hv); }
            };
            gemm_tile<256, 128>(lds, la, lb, DM / 64, epi);
        }
        SEAM(7);
    }

    if (IN_PH(8)) {
        const float* rb = INF(25);
        for (int t = bid * 64 + tid; t < T && tid < 64; t += G * 64) {
            const float* lg = LOGITS + (size_t)t * NE;
            float gs[8];
#pragma unroll
            for (int g = 0; g < 8; ++g) {
                float m1 = -1e30f, m2 = -1e30f;
                for (int j4 = 0; j4 < 8; ++j4) {
                    const f32x4 v = *(const f32x4*)(lg + g * 32 + j4 * 4); const f32x4 bv = *(const f32x4*)(rb + g * 32 + j4 * 4);
#pragma unroll
                    for (int e = 0; e < 4; ++e) { const float s = 1.f / (1.f + expf(-v[e])) + bv[e];
                        if (s > m1) { m2 = m1; m1 = s; } else if (s > m2) m2 = s; }
                }
                gs[g] = m1 + m2;
            }
            unsigned gmask = 0u;
#pragma unroll
            for (int g = 0; g < 8; ++g) { int rank = 0;
#pragma unroll
                for (int g2 = 0; g2 < 8; ++g2) rank += (gs[g2] > gs[g] || (gs[g2] == gs[g] && g2 < g)) ? 1 : 0;
                if (rank < 4) gmask |= 1u << g; }
            float tv[8]; int ti[8];
#pragma unroll
            for (int k = 0; k < 8; ++k) { tv[k] = -1e30f; ti[k] = 0; }
            for (int g = 0; g < 8; ++g) {
                if (!((gmask >> g) & 1u)) continue;
                for (int j4 = 0; j4 < 8; ++j4) {
                    const f32x4 v = *(const f32x4*)(lg + g * 32 + j4 * 4); const f32x4 bv = *(const f32x4*)(rb + g * 32 + j4 * 4);
#pragma unroll
                    for (int e = 0; e < 4; ++e) {
                        float s = 1.f / (1.f + expf(-v[e])) + bv[e]; int id = g * 32 + j4 * 4 + e;
                        if (s > tv[7]) {
                            tv[7] = s; ti[7] = id;
#pragma unroll
                            for (int k = 7; k >= 1; --k) { if (tv[k] > tv[k - 1]) { const float fv = tv[k]; tv[k] = tv[k - 1]; tv[k - 1] = fv; const int iv = ti[k]; ti[k] = ti[k - 1]; ti[k - 1] = iv; } }
                        }
                    }
                }
            }
            float sc[8], ssum = 0.f;
#pragma unroll
            for (int k = 0; k < 8; ++k) { sc[k] = 1.f / (1.f + expf(-lg[ti[k]])); ssum += sc[k]; }
            const float inv = 2.5f / ssum;
#pragma unroll
            for (int k = 0; k < 8; ++k) {
                GATES[t * 8 + k] = sc[k] * inv;
                const unsigned ps = atomicAdd(&ecnt[ti[k]], 1u);
                LISTS[(size_t)ti[k] * T + ps] = t * 8 + k;
            }
        }
        SEAM(8);
    }

    if (IN_PH(9) || IN_PH(10)) {
        LAS int* pre = (LAS int*)(lds + 131072);
        LAS int* rows = (LAS int*)(lds + 131072 + 1040);
        for (int ph = 9; ph <= 10; ++ph) {
            if (!IN_PH(ph)) continue;
            __syncthreads();
            if (tid == 0) { int s = 0; for (int e = 0; e < NE; ++e) { pre[e] = s; s += ((int)ecnt[e] + 255) >> 8; } pre[NE] = s; }
            __syncthreads();
            const int ntile = pre[NE];
            if (ph == 9) {
                const float* wg = INF(26); const float* wu = INF(27);
                for (int u = bid; u < ntile * 4; u += G) {
                    const int tl = u >> 2, pn = u & 3;
                    int e = 0; { int lo2 = 0, hi2 = NE; while (hi2 - lo2 > 1) { const int mid = (lo2 + hi2) >> 1; if (pre[mid] <= tl) lo2 = mid; else hi2 = mid; } e = lo2; }
                    const int m0 = (tl - pre[e]) * 256, cnt = (int)ecnt[e];
                    __syncthreads();
                    if (tid < 256) rows[tid] = (m0 + tid < cnt) ? LISTS[(size_t)e * T + m0 + tid] : -1;
                    __syncthreads();
                    LdBf16<4> la; la.base = (const unsigned char*)H1B; la.ldsoff = (tid >> 3) * LDT + (tid & 7) * 16;
#pragma unroll
                    for (int i = 0; i < 4; ++i) { const int s = rows[(tid >> 3) + 64 * i]; const int tok = s < 0 ? 0 : (s >> 3);
                        la.off[i] = (unsigned)((tok * DM + (tid & 7) * 8) * 2); }
                    LdF32KN<128, false> lb; const int n = tid & 127, kc0 = tid >> 7;
                    { const int q = n & 63, wcx = n >> 6; const float* src = ((q < 32) ? wg : wu) + (size_t)e * DM * ED;
                      lb.p = src + (size_t)(kc0 * 8) * ED + pn * 64 + wcx * 32 + (q & 31); }
                    lb.N = ED; lb.scale = 1.f; lb.kc0 = kc0; lb.ldsoff = n * LDT + kc0 * 16;
                    auto epi = [&](const f32x4 (&acc)[4][4], int wr, int wc, int fr, int fq) {
#pragma unroll
                        for (int m = 0; m < 4; ++m)
#pragma unroll
                            for (int j = 0; j < 4; ++j) {
                                const int s = rows[wr * 64 + m * 16 + fq * 4 + j];
                                if (s >= 0) {
#pragma unroll
                                    for (int nn = 0; nn < 2; ++nn) {
                                        const int col = pn * 64 + wc * 32 + nn * 16 + fr;
                                        const float gv = acc[m][nn][j], uv = acc[m][nn + 2][j];
                                        const float hv = gv / (1.f + __expf(-gv)) * uv;
                                        HEXP[(size_t)s * ED + col] = f2bf(hv); } } }
                    };
                    gemm_tile<256, 128>(lds, la, lb, DM / 64, epi);
                }
                SEAM(9);
            } else {
                const float* wd = INF(28);
                for (int u = bid; u < ntile * 8; u += G) {
                    const int tl = u >> 3, pn = u & 7;
                    int e = 0; { int lo2 = 0, hi2 = NE; while (hi2 - lo2 > 1) { const int mid = (lo2 + hi2) >> 1; if (pre[mid] <= tl) lo2 = mid; else hi2 = mid; } e = lo2; }
                    const int m0 = (tl - pre[e]) * 256, cnt = (int)ecnt[e];
                    __syncthreads();
                    if (tid < 256) rows[tid] = (m0 + tid < cnt) ? LISTS[(size_t)e * T + m0 + tid] : -1;
                    __syncthreads();
                    LdBf16<4> la; la.base = (const unsigned char*)HEXP; la.ldsoff = (tid >> 3) * LDT + (tid & 7) * 16;
#pragma unroll
                    for (int i = 0; i < 4; ++i) { const int s = rows[(tid >> 3) + 64 * i]; const int sl = s < 0 ? 0 : s;
                        la.off[i] = (unsigned)((sl * ED + (tid & 7) * 8) * 2); }
                    LdF32KN<128, false> lb; const int n = tid & 127, kc0 = tid >> 7;
                    lb.p = wd + (size_t)e * ED * DM + (size_t)(kc0 * 8) * DM + pn * 128 + n; lb.N = DM; lb.scale = 1.f; lb.kc0 = kc0; lb.ldsoff = n * LDT + kc0 * 16;
                    auto epi = [&](const f32x4 (&acc)[4][4], int wr, int wc, int fr, int fq) {
#pragma unroll
                        for (int m = 0; m < 4; ++m)
#pragma unroll
                            for (int j = 0; j < 4; ++j) {
                                const int s = rows[wr * 64 + m * 16 + fq * 4 + j];
                                if (s >= 0) { const float gt = GATES[s];
#pragma unroll
                                    for (int nn = 0; nn < 4; ++nn) {
                                        const int col = pn * 128 + wc * 64 + nn * 16 + fr;
                                        YSLOTS[(size_t)s * DM + col] = f2bf(acc[m][nn][j] * gt); } } }
                    };
                    gemm_tile<256, 128>(lds, la, lb, ED / 64, epi);
                }
                const float* wsd = INF(31);
                for (int u = bid; u < (T / 256) * (DM / 128); u += G) {
                    const int pn = u % (DM / 128), pm = u / (DM / 128);
                    LdBf16<4> la; la.base = (const unsigned char*)HS; la.ldsoff = (tid >> 3) * LDT + (tid & 7) * 16;
#pragma unroll
                    for (int i = 0; i < 4; ++i) la.off[i] = (unsigned)(((pm * 256 + (tid >> 3) + 64 * i) * ED + (tid & 7) * 8) * 2);
                    LdF32KN<128, false> lb; const int n = tid & 127, kc0 = tid >> 7;
                    lb.p = wsd + (size_t)(kc0 * 8) * DM + pn * 128 + n; lb.N = DM; lb.scale = 1.f; lb.kc0 = kc0; lb.ldsoff = n * LDT + kc0 * 16;
                    auto epi = [&](const f32x4 (&acc)[4][4], int wr, int wc, int fr, int fq) {
#pragma unroll
                        for (int m = 0; m < 4; ++m)
#pragma unroll
                            for (int nn = 0; nn < 4; ++nn)
#pragma unroll
                                for (int j = 0; j < 4; ++j) {
                                    const int row = pm * 256 + wr * 64 + m * 16 + fq * 4 + j, col = pn * 128 + wc * 64 + nn * 16 + fr;
                                    YSH[(size_t)row * DM + col] = acc[m][nn][j]; }
                    };
                    gemm_tile<256, 128>(lds, la, lb, ED / 64, epi);
                }
                SEAM(10);
            }
        }
    }


#if DEBUG_TAP >= 0
    {
        unsigned* flagw = (unsigned*)(ws + WS_CTL + 15872);
        auto scan_bf16 = [&](const bf16_t* ptr, size_t n, int ld, int c0, int c1, unsigned bit) {
            unsigned bad = 0u; const size_t rows = n / ld; const int w = c1 - c0;
            for (size_t i = (size_t)bid * 512 + tid; i < rows * w; i += (size_t)G * 512) { const size_t r = i / w; const int c = c0 + (int)(i % w);
                const unsigned v = ptr[r * ld + c]; if ((v & 0x7F80u) == 0x7F80u) bad = 1u; }
            if (bad) atomicOr(flagw, bit); };
        auto scan_f32 = [&](const float* ptr, size_t n, unsigned bit) {
            unsigned bad = 0u;
            for (size_t i = (size_t)bid * 512 + tid; i < n; i += (size_t)G * 512) { const float v = ptr[i]; if (!(fabsf(v) < 1e30f)) bad = 1u; }
            if (bad) atomicOr(flagw, bit); };
        if (args.ph_lo <= 11 && 11 < args.ph_hi) {
            scan_bf16(H0B, (size_t)T * DM, DM, 0, DM, 1u << 0);
            scan_bf16(PROJ, (size_t)T * INC, INC, 0, 512, 1u << 1);
            scan_bf16(PROJ, (size_t)T * INC, INC, 512, 1024, 1u << 2);
            scan_bf16(PROJ, (size_t)T * INC, INC, 1024, 1536, 1u << 3);
            scan_bf16(PROJ, (size_t)T * INC, INC, 1536, 3072, 1u << 4);
            scan_f32(HFILT, (size_t)1024 * SEQ, 1u << 5);
            scan_f32((const float*)TW, 2 * NFFT, 1u << 6);
            scan_bf16(X0, (size_t)T * CH, CH, 0, CH, 1u << 7);
            scan_f32(VXT, (size_t)NBATCH * CH * SEQ, 1u << 8);
            scan_f32((const float*)GS, (size_t)256 * 2 * NFFT, 1u << 9);
            scan_f32(YT, (size_t)NBATCH * CH * SEQ, 1u << 10);
            scan_bf16(CONCAT, (size_t)T * DM, DM, 0, 512, 1u << 11);
            scan_bf16(CONCAT, (size_t)T * DM, DM, 512, 1024, 1u << 12);
            scan_f32(R1, (size_t)T * DM, 1u << 13);
        }
        if (args.ph_lo <= 12 && 12 < args.ph_hi) {
            const unsigned f = __hip_atomic_load(flagw, __ATOMIC_RELAXED, __HIP_MEMORY_SCOPE_AGENT);
            float val = 1.0f;
            if (f) { const int fb = __ffs((int)f) - 1; val = exp2f((float)(fb + 1)); }
            for (size_t i = (size_t)bid * 512 + tid; i < (size_t)T * DM; i += (size_t)G * 512) args.out[i] = val;
        }
    }
#endif
    if (DEBUG_TAP < 0 && IN_PH(11)) {
        const float* g = INF(32); const float* bta = INF(33);
        for (int row = bid * 8 + wid; row < T; row += G * 8) {
            f32x4 v[4]; float s = 0.f;
#pragma unroll
            for (int i = 0; i < 4; ++i) { const int c = (lane + 64 * i) * 4;
                v[i] = ALPHA * *(const f32x4*)(H1F + (size_t)row * DM + c) + *(const f32x4*)(YSH + (size_t)row * DM + c); }
#pragma unroll 1
            for (int k = 0; k < 8; ++k) {
                const bf16_t* ys = YSLOTS + (size_t)(row * 8 + k) * DM;
#pragma unroll
                for (int i = 0; i < 4; ++i) { const u32x2 w = *(const u32x2*)(ys + (lane + 64 * i) * 4);
                    v[i][0] += bflo(w.x); v[i][1] += bfhi(w.x); v[i][2] += bflo(w.y); v[i][3] += bfhi(w.y); }
            }
#pragma unroll
            for (int i = 0; i < 4; ++i) s += (v[i][0] + v[i][1]) + (v[i][2] + v[i][3]);
            const float mean = wave_sum(s) * (1.f / DM); float q = 0.f;
#pragma unroll
            for (int i = 0; i < 4; ++i) { const f32x4 d = v[i] - mean; q += (d[0] * d[0] + d[1] * d[1]) + (d[2] * d[2] + d[3] * d[3]); }
            const float rstd = rsqrtf(wave_sum(q) * (1.f / DM) + LN_EPS);
#pragma unroll
            for (int i = 0; i < 4; ++i) { const int c = (lane + 64 * i) * 4; const f32x4 gg = *(const f32x4*)(g + c), bb = *(const f32x4*)(bta + c);
                *(f32x4*)(args.out + (size_t)row * DM + c) = (v[i] - mean) * rstd * gg + bb; }
        }
    }
}

extern "C" void kernel_launch(void* const* d_in, const int* in_sizes, int n_in, void* d_out, int out_size, void* d_ws, size_t ws_size, hipStream_t stream) {
    static int grid = 0;
    if (grid == 0) {
        if (n_in != 34 || out_size != T * DM || ws_size < WS_END) { fprintf(stderr, "kernel_launch: unexpected shapes (n_in %d, out %d, ws %zu)\n", n_in, out_size, ws_size); grid = -1; return; }
        int dev = 0, cus = 0, per_cu = 0;
        if (hipGetDevice(&dev) != hipSuccess || hipDeviceGetAttribute(&cus, hipDeviceAttributeMultiprocessorCount, dev) != hipSuccess) { grid = -1; return; }
        if (hipFuncSetAttribute((const void*)mk_fwd, hipFuncAttributeMaxDynamicSharedMemorySize, LDS_BYTES) != hipSuccess) { fprintf(stderr, "kernel_launch: hipFuncSetAttribute failed\n"); grid = -1; return; }
        if (hipOccupancyMaxActiveBlocksPerMultiprocessor(&per_cu, (const void*)mk_fwd, 512, LDS_BYTES) != hipSuccess || per_cu < 1) { fprintf(stderr, "kernel_launch: occupancy query says %d\n", per_cu); }
        (void)hipGetLastError();
        grid = cus;
    }
    if (grid < 0) return;
    if (hipMemsetAsync((char*)d_ws + WS_CTL, 0, CTL_BYTES, stream) != hipSuccess) return;
    Args a{};
    for (int i = 0; i < 34; ++i) a.in[i] = d_in[i];
    a.out = (float*)d_out; a.ws = (unsigned char*)d_ws;
#if MK_LAUNCHES == 1
    a.ph_lo = 0; a.ph_hi = NPHASE;
    hipLaunchKernelGGL(mk_fwd, dim3(grid), dim3(512), LDS_BYTES, stream, a);
#else
    for (int p = 0; p < NPHASE; ++p) { a.ph_lo = p; a.ph_hi = p + 1; hipLaunchKernelGGL(mk_fwd, dim3(grid), dim3(512), LDS_BYTES, stream, a); }
#endif
    const hipError_t le = hipPeekAtLastError();
    if (le != hipSuccess) fprintf(stderr, "kernel_launch: launch failed: %s\n", hipGetErrorName(le));
}
```
